# Optimizing an MI355X kernel written in HIP

```python
import jax, jax.numpy as jnp
from jax import lax
import numpy as np

D_MODEL = 1024
BATCH = 16
SEQ = 2048
DEPTH = 4

HEAD_DIM = 64
N_FOX_HEADS = 8
N_MOBA_HEADS = 8
FOX_WIDTH = N_FOX_HEADS * HEAD_DIM
MOBA_WIDTH = N_MOBA_HEADS * HEAD_DIM
ATTN_WIDTH = FOX_WIDTH + MOBA_WIDTH
FOX_Q_BLOCK = 128
MOBA_BLOCK = 256
MOBA_TOPK = 3
MOBA_Q_CHUNK = 16
POOL_EXPAND = 2
POOL_WIDTH = POOL_EXPAND * D_MODEL
POOL_WINDOWS = (2, 4, 8, 16)
POOL_GROUP = POOL_WIDTH // len(POOL_WINDOWS)
ATTN_SPLIT_SIZES = (FOX_WIDTH, FOX_WIDTH, FOX_WIDTH, FOX_WIDTH, N_FOX_HEADS,
                    MOBA_WIDTH, MOBA_WIDTH, MOBA_WIDTH, MOBA_WIDTH)
ATTN_IN = sum(ATTN_SPLIT_SIZES)
DEEPNORM_ALPHA = (2 * DEPTH) ** 0.25
DEEPNORM_BETA = (8 * DEPTH) ** -0.25
LN_EPS = 1e-5
N_ATTN_LAYERS = (DEPTH + 1) // 2
N_POOL_LAYERS = DEPTH // 2

kernel_name = "fox_moba_pool_deepnorm_hybrid"


def layer_norm(x, g, b):
    xf = x.astype(jnp.float32)
    mu = jnp.mean(xf, axis=-1, keepdims=True)
    var = jnp.mean(jnp.square(xf - mu), axis=-1, keepdims=True)
    y = (xf - mu) * lax.rsqrt(var + LN_EPS) * g.astype(jnp.float32) + b.astype(jnp.float32)
    return y.astype(x.dtype)


def split_heads(t, n_heads):
    B, S, _ = t.shape
    return t.reshape(B, S, n_heads, HEAD_DIM).transpose(0, 2, 1, 3)


def merge_heads(t):
    B, H, S, Dh = t.shape
    return t.transpose(0, 2, 1, 3).reshape(B, S, H * Dh)


def fox_attention(q, k, v, log_f):
    B, H, S, Dh = q.shape
    c = jnp.cumsum(log_f, axis=-1)
    nq = S // FOX_Q_BLOCK
    qb = q.reshape(B, H, nq, FOX_Q_BLOCK, Dh).transpose(2, 0, 1, 3, 4)
    cb = c.reshape(B, H, nq, FOX_Q_BLOCK).transpose(2, 0, 1, 3)
    key_pos = jnp.arange(S)
    scale = Dh ** -0.5

    def block(args):
        i, q_i, c_i = args
        s = jnp.einsum('bhqd,bhkd->bhqk', q_i, k, preferred_element_type=jnp.float32) * scale
        s = s + (c_i[..., :, None] - c[..., None, :])
        q_pos = i * FOX_Q_BLOCK + jnp.arange(FOX_Q_BLOCK)
        s = jnp.where(key_pos[None, :] <= q_pos[:, None], s, -jnp.inf)
        p = jax.nn.softmax(s, axis=-1)
        return jnp.einsum('bhqk,bhkd->bhqd', p.astype(v.dtype), v)

    out = lax.map(block, (jnp.arange(nq), qb, cb))
    return out.transpose(1, 2, 0, 3, 4).reshape(B, H, S, Dh)


def moba_attention(q, k, v):
    B, H, S, Dh = q.shape
    nb = -(-S // MOBA_BLOCK)
    pad = nb * MOBA_BLOCK - S
    kb = jnp.pad(k, ((0, 0), (0, 0), (0, pad), (0, 0))).reshape(B, H, nb, MOBA_BLOCK, Dh)
    vb = jnp.pad(v, ((0, 0), (0, 0), (0, pad), (0, 0))).reshape(B, H, nb, MOBA_BLOCK, Dh)
    k_mean = jnp.mean(kb.astype(jnp.float32), axis=3)
    gate = jnp.einsum('bhsd,bhnd->bhsn', q.astype(jnp.float32), k_mean)
    q_blk = jnp.arange(S) // MOBA_BLOCK
    fully_past = jnp.arange(nb)[None, :] < q_blk[:, None]
    gate = jnp.where(fully_past, gate, -jnp.inf)
    kk = min(MOBA_TOPK, nb)
    top_val, top_idx = lax.top_k(gate, kk)
    valid = jnp.isfinite(top_val)

    C = MOBA_Q_CHUNK
    nc = S // C
    qc = q.reshape(B, H, nc, C, Dh).transpose(2, 0, 1, 3, 4)
    idx_c = top_idx.reshape(B, H, nc, C, kk).transpose(2, 0, 1, 3, 4)
    val_c = valid.reshape(B, H, nc, C, kk).transpose(2, 0, 1, 3, 4)
    scale = Dh ** -0.5
    gather = jax.vmap(jax.vmap(lambda blocks, ids: blocks[ids]))

    def chunk(args):
        i, q_i, idx_i, valid_i = args
        start = i * C
        blk = start // MOBA_BLOCK
        k_own = lax.dynamic_index_in_dim(kb, blk, axis=2, keepdims=False)
        v_own = lax.dynamic_index_in_dim(vb, blk, axis=2, keepdims=False)
        s_own = jnp.einsum('bhqd,bhkd->bhqk', q_i, k_own, preferred_element_type=jnp.float32) * scale
        q_pos = start + jnp.arange(C)
        k_pos = blk * MOBA_BLOCK + jnp.arange(MOBA_BLOCK)
        s_own = jnp.where(k_pos[None, :] <= q_pos[:, None], s_own, -jnp.inf)
        k_sel = gather(kb, idx_i)
        v_sel = gather(vb, idx_i)
        s_sel = jnp.einsum('bhqd,bhqnkd->bhqnk', q_i, k_sel, preferred_element_type=jnp.float32) * scale
        s_sel = jnp.where(valid_i[..., None], s_sel, -jnp.inf).reshape(B, H, C, kk * MOBA_BLOCK)
        p = jax.nn.softmax(jnp.concatenate([s_sel, s_own], axis=-1), axis=-1).astype(v.dtype)
        p_sel = p[..., :kk * MOBA_BLOCK].reshape(B, H, C, kk, MOBA_BLOCK)
        p_own = p[..., kk * MOBA_BLOCK:]
        return (jnp.einsum('bhqnk,bhqnkd->bhqd', p_sel, v_sel)
                + jnp.einsum('bhqk,bhkd->bhqd', p_own, v_own))

    out = lax.map(chunk, (jnp.arange(nc), qc, idx_c, val_c))
    return out.transpose(1, 2, 0, 3, 4).reshape(B, H, S, Dh)


def causal_multiscale_pool(u):
    B, S, W = u.shape
    uf = u.astype(jnp.float32)
    cs = jnp.pad(jnp.cumsum(uf, axis=1), ((0, 0), (1, 0), (0, 0)))
    t = jnp.arange(S)
    outs = []
    for g, w in enumerate(POOL_WINDOWS):
        cs_g = cs[..., g * POOL_GROUP:(g + 1) * POOL_GROUP]
        lo = jnp.maximum(t + 1 - w, 0)
        cnt = jnp.minimum(t + 1, w).astype(jnp.float32)
        outs.append((cs_g[:, t + 1] - cs_g[:, lo]) / cnt[None, :, None])
    return (jnp.concatenate(outs, axis=-1) - uf).astype(u.dtype)


def attn_sublayer(x, w_in, b_f, w_out):
    h = x @ w_in
    offsets = [int(o) for o in np.cumsum(ATTN_SPLIT_SIZES)[:-1]]
    fq, fk, fv, fg, ff, mq, mk, mv, mg = jnp.split(h, offsets, axis=-1)
    log_f = jax.nn.log_sigmoid((ff + b_f).astype(jnp.float32)).transpose(0, 2, 1)
    y_fox = fox_attention(split_heads(fq, N_FOX_HEADS), split_heads(fk, N_FOX_HEADS),
                          split_heads(fv, N_FOX_HEADS), log_f)
    y_moba = moba_attention(split_heads(mq, N_MOBA_HEADS), split_heads(mk, N_MOBA_HEADS),
                            split_heads(mv, N_MOBA_HEADS))
    y = jnp.concatenate([merge_heads(y_fox) * jax.nn.silu(fg),
                         merge_heads(y_moba) * jax.nn.silu(mg)], axis=-1)
    return y @ w_out


def pool_sublayer(x, w_in, w_grp, scale, w_out):
    B, S, _ = x.shape
    h = x @ w_in
    u, gate = h[..., :POOL_WIDTH], h[..., POOL_WIDTH:]
    pooled = causal_multiscale_pool(u).reshape(B, S, len(POOL_WINDOWS), POOL_GROUP)
    y = jnp.einsum('bsgc,gcd->bsgd', pooled, w_grp).reshape(B, S, POOL_WIDTH) * scale
    return (y * jax.nn.silu(gate)) @ w_out


def setup_inputs(seed: int = 0) -> dict:
    key = jax.random.key(seed)
    ks = jax.random.split(key, 12)
    f32 = jnp.float32
    x = jax.random.normal(ks[0], (BATCH, SEQ, D_MODEL), f32)
    attn_w_in = jax.random.normal(ks[1], (N_ATTN_LAYERS, D_MODEL, ATTN_IN), f32) * D_MODEL ** -0.5
    attn_b_f = jax.random.uniform(ks[2], (N_ATTN_LAYERS, N_FOX_HEADS), f32, 1.0, 4.0)
    attn_w_out = (jax.random.normal(ks[3], (N_ATTN_LAYERS, ATTN_WIDTH, D_MODEL), f32)
                  * ATTN_WIDTH ** -0.5 * DEEPNORM_BETA)
    pool_w_in = jax.random.normal(ks[4], (N_POOL_LAYERS, D_MODEL, 2 * POOL_WIDTH), f32) * D_MODEL ** -0.5
    pool_w_grp = (jax.random.normal(ks[5], (N_POOL_LAYERS, len(POOL_WINDOWS), POOL_GROUP, POOL_GROUP), f32)
                  * POOL_GROUP ** -0.5)
    pool_scale = 1.0 + 0.1 * jax.random.normal(ks[6], (N_POOL_LAYERS, POOL_WIDTH), f32)
    pool_w_out = (jax.random.normal(ks[7], (N_POOL_LAYERS, POOL_WIDTH, D_MODEL), f32)
                  * POOL_WIDTH ** -0.5 * DEEPNORM_BETA)
    ln_g = 1.0 + 0.02 * jax.random.normal(ks[8], (DEPTH, D_MODEL), f32)
    ln_b = 0.02 * jax.random.normal(ks[9], (DEPTH, D_MODEL), f32)
    return {"x": x, "attn_w_in": attn_w_in, "attn_b_f": attn_b_f, "attn_w_out": attn_w_out,
            "pool_w_in": pool_w_in, "pool_w_grp": pool_w_grp, "pool_scale": pool_scale,
            "pool_w_out": pool_w_out, "ln_g": ln_g, "ln_b": ln_b}


def reference(x, attn_w_in, attn_b_f, attn_w_out, pool_w_in, pool_w_grp, pool_scale,
              pool_w_out, ln_g, ln_b):
    for layer in range(DEPTH):
        j = layer // 2
        if layer % 2 == 0:
            f = attn_sublayer(x, attn_w_in[j], attn_b_f[j], attn_w_out[j])
        else:
            f = pool_sublayer(x, pool_w_in[j], pool_w_grp[j], pool_scale[j], pool_w_out[j])
        x = layer_norm(DEEPNORM_ALPHA * x + f, ln_g[layer], ln_b[layer])
    return x
```

```cpp
#include <hip/hip_runtime.h>
#include <cstdio>
#include <cstdint>
#include <cmath>

typedef unsigned short bf16_t;
typedef short bf16x8 __attribute__((ext_vector_type(8)));
typedef float f32x4 __attribute__((ext_vector_type(4)));
typedef unsigned u32x4 __attribute__((ext_vector_type(4)));

constexpr int BATCH = 16, SEQ = 2048, DM = 1024, MROWS = BATCH * SEQ;
constexpr int NH = 8, HD = 64;
constexpr int HW = 4096;
constexpr int PW = 2048;
constexpr float ALPHA = 1.681792830507429f;
constexpr float LN_EPS = 1e-5f;
constexpr float LOG2E = 1.4426950408889634f;
constexpr float C2 = 0.125f * LOG2E;

constexpr size_t MiB = 1u << 20;
constexpr size_t WS_CTL = 0;
constexpr size_t WS_LF = 1 * MiB;
constexpr size_t WS_DK = 2 * MiB;
constexpr size_t WS_KMS = 3 * MiB;
constexpr size_t WS_XB = 4 * MiB;
constexpr size_t WS_WINA = 8 * MiB;
constexpr size_t WS_WFFA = 24 * MiB;
constexpr size_t WS_WOUTA = 25 * MiB;
constexpr size_t WS_WINP = 29 * MiB;
constexpr size_t WS_WGP = 45 * MiB;
constexpr size_t WS_WOUTP = 49 * MiB;
constexpr size_t WS_XN = 60 * MiB;
constexpr size_t WS_R0 = 124 * MiB, WS_R1 = 252 * MiB, WS_R2 = 380 * MiB, WS_END = 508 * MiB;

__device__ __forceinline__ unsigned f2bf(float f) { unsigned u = __builtin_bit_cast(unsigned, f); return (u + 0x7fffu + ((u >> 16) & 1u)) >> 16; }
__device__ __forceinline__ float bf2f(unsigned short b) { return __builtin_bit_cast(float, (unsigned)b << 16); }
__device__ __forceinline__ float silu_f(float g) { return g / (1.0f + expf(-g)); }

__global__ __launch_bounds__(256) void s_wt(const float* __restrict__ src, int ldsrc, int col0, int K, int ncols, bf16_t* __restrict__ dst) {
    __shared__ float t[32][33];
    const int n0 = blockIdx.x * 32, k0 = blockIdx.y * 32, tx = threadIdx.x & 31, ty = threadIdx.x >> 5;
    for (int i = ty; i < 32; i += 8) t[i][tx] = src[(size_t)(k0 + i) * ldsrc + col0 + n0 + tx];
    __syncthreads();
    for (int i = ty; i < 32; i += 8) dst[(size_t)(n0 + i) * K + k0 + tx] = (bf16_t)f2bf(t[tx][i]);
}
__global__ void s_zero16(bf16_t* p, int n) { int i = blockIdx.x * blockDim.x + threadIdx.x; if (i < n) p[i] = 0; }
__global__ void s_cvt(const float* __restrict__ x, bf16_t* __restrict__ o, size_t n4) {
    size_t i = (size_t)blockIdx.x * blockDim.x + threadIdx.x; if (i >= n4) return;
    f32x4 v = ((const f32x4*)x)[i]; unsigned lo = f2bf(v[0]) | (f2bf(v[1]) << 16), hi = f2bf(v[2]) | (f2bf(v[3]) << 16);
    ((uint2*)o)[i] = make_uint2(lo, hi);
}

struct EpiInAttn { bf16_t* H; __device__ void operator()(int r, int c, float v) const { const int t = c >> 9; if (t == 0 || t == 4) v *= C2; H[(size_t)r * HW + c] = (bf16_t)f2bf(v); } };
struct EpiInPool { bf16_t* U; bf16_t* G; __device__ void operator()(int r, int c, float v) const { if (c < PW) U[(size_t)r * PW + c] = (bf16_t)f2bf(v); else G[(size_t)r * PW + c - PW] = (bf16_t)f2bf(v); } };
struct EpiGrp { const bf16_t* G; const float* scale; bf16_t* Y; __device__ void operator()(int r, int c, float v) const { const float g = bf2f(G[(size_t)r * PW + c]); Y[(size_t)r * PW + c] = (bf16_t)f2bf(v * scale[c] * silu_f(g)); } };
struct EpiF32 { float* F; __device__ void operator()(int r, int c, float v) const { F[(size_t)r * DM + c] = v; } };

template <class Epi> __global__ __launch_bounds__(256) void s_gemm(const bf16_t* __restrict__ A, int lda, const bf16_t* __restrict__ Bt, int ldb, int K, Epi E, int a_goff, int b_goff, int c_goff) {
    __shared__ __attribute__((aligned(16))) bf16_t sA[128][40];
    __shared__ __attribute__((aligned(16))) bf16_t sB[128][40];
    const int tid = threadIdx.x, lane = tid & 63, w = tid >> 6, wr = w >> 1, wc = w & 1, fr = lane & 15, fq = lane >> 4;
    const int g = blockIdx.z, m0 = blockIdx.y * 128, n0 = blockIdx.x * 128;
    A += (size_t)g * a_goff; Bt += (size_t)g * b_goff;
    f32x4 acc[4][4];
#pragma unroll
    for (int i = 0; i < 4; ++i)
#pragma unroll
        for (int j = 0; j < 4; ++j) acc[i][j] = (f32x4){0.f, 0.f, 0.f, 0.f};
    for (int k0 = 0; k0 < K; k0 += 32) {
#pragma unroll
        for (int i = 0; i < 2; ++i) { const int ch = tid + i * 256, r = ch >> 2, c = (ch & 3) * 8;
            *(u32x4*)&sA[r][c] = *(const u32x4*)(A + (size_t)(m0 + r) * lda + k0 + c);
            *(u32x4*)&sB[r][c] = *(const u32x4*)(Bt + (size_t)(n0 + r) * ldb + k0 + c); }
        __syncthreads();
        bf16x8 a[4], b[4];
#pragma unroll
        for (int i = 0; i < 4; ++i) { a[i] = *(const bf16x8*)&sA[wr * 64 + i * 16 + fr][fq * 8]; b[i] = *(const bf16x8*)&sB[wc * 64 + i * 16 + fr][fq * 8]; }
#pragma unroll
        for (int i = 0; i < 4; ++i)
#pragma unroll
            for (int j = 0; j < 4; ++j) acc[i][j] = __builtin_amdgcn_mfma_f32_16x16x32_bf16(a[i], b[j], acc[i][j], 0, 0, 0);
        __syncthreads();
    }
#pragma unroll
    for (int i = 0; i < 4; ++i)
#pragma unroll
        for (int j = 0; j < 4; ++j)
#pragma unroll
            for (int r = 0; r < 4; ++r) E(m0 + wr * 64 + i * 16 + fq * 4 + r, g * c_goff + n0 + wc * 64 + j * 16 + fr, acc[i][j][r]);
}

__global__ __launch_bounds__(256) void s_ff(const bf16_t* __restrict__ XN, const bf16_t* __restrict__ Wff, const float* __restrict__ bfg, float* __restrict__ LF) {
    const int lane = threadIdx.x & 63, m = blockIdx.x * 4 + (threadIdx.x >> 6);
    float xv[16];
#pragma unroll
    for (int j = 0; j < 2; ++j) { const bf16x8 v = *(const bf16x8*)(XN + (size_t)m * DM + j * 512 + lane * 8);
#pragma unroll
        for (int e = 0; e < 8; ++e) xv[j * 8 + e] = bf2f((unsigned short)v[e]); }
#pragma unroll
    for (int h = 0; h < 8; ++h) { float s = 0.f;
#pragma unroll
        for (int j = 0; j < 2; ++j) { const bf16x8 wv = *(const bf16x8*)(Wff + (size_t)h * DM + j * 512 + lane * 8);
#pragma unroll
            for (int e = 0; e < 8; ++e) s += xv[j * 8 + e] * bf2f((unsigned short)wv[e]); }
#pragma unroll
        for (int o = 1; o < 64; o <<= 1) s += __shfl_xor(s, o);
        if (lane == 0) { const float z = s + bfg[h]; LF[(size_t)m * 8 + h] = -(fmaxf(-z, 0.f) + log1pf(expf(-fabsf(z)))); } }
}
__global__ __launch_bounds__(256) void s_cumsum(const float* __restrict__ LF, float* __restrict__ DK) {
    __shared__ float part[256];
    const int bh = blockIdx.x, b = bh >> 3, h = bh & 7, tid = threadIdx.x;
    float v[8]; float s = 0.f;
#pragma unroll
    for (int i = 0; i < 8; ++i) { s += LF[((size_t)b * SEQ + tid * 8 + i) * 8 + h]; v[i] = s; }
    part[tid] = s; __syncthreads();
    float off = 0.f; for (int i = 0; i < tid; ++i) off += part[i];
#pragma unroll
    for (int i = 0; i < 8; ++i) DK[(size_t)bh * SEQ + tid * 8 + i] = -(off + v[i]) * LOG2E;
}
__global__ __launch_bounds__(64) void s_kms(const bf16_t* __restrict__ H, float* __restrict__ KMS) {
    const int i = blockIdx.x, n = i & 7, h = (i >> 3) & 7, b = i >> 6, d = threadIdx.x;
    const bf16_t* p = H + ((size_t)b * SEQ + n * 256) * HW + 5 * 512 + h * HD + d; float s = 0.f;
    for (int r = 0; r < 256; ++r) s += bf2f(p[(size_t)r * HW]);
    KMS[(size_t)i * 64 + d] = s;
}
template <int MODE> __global__ __launch_bounds__(256) void s_attn(const bf16_t* __restrict__ H, const float* __restrict__ DK, const float* __restrict__ KMS, bf16_t* __restrict__ Y) {
    const int blk = blockIdx.x, qb = blk & 7, h = (blk >> 3) & 7, b = blk >> 6, tid = threadIdx.x;
    const int t = qb * 256 + tid; const size_t row = (size_t)b * SEQ + t;
    const int cq = (MODE ? 4 : 0) * 512 + h * HD, ck = cq + 512, cv = cq + 1024, cg = cq + 1536;
    float q[64], o[64];
#pragma unroll
    for (int c = 0; c < 8; ++c) { const bf16x8 v = *(const bf16x8*)(H + row * HW + cq + c * 8);
#pragma unroll
        for (int e = 0; e < 8; ++e) { q[c * 8 + e] = bf2f((unsigned short)v[e]); o[c * 8 + e] = 0.f; } }
    const bf16_t* Kb = H + (size_t)b * SEQ * HW + ck; const bf16_t* Vb = H + (size_t)b * SEQ * HW + cv;
    const float* dk = DK + (size_t)(b * 8 + h) * SEQ;
    float m = -INFINITY, l = 0.f;
    const int tmax = qb * 256 + (tid | 63);
#define ATT_KEY(j, valid) do { \
        const bf16_t* kr = Kb + (size_t)(j) * HW; float s = 0.f; \
        _Pragma("unroll") for (int c = 0; c < 8; ++c) { const bf16x8 kv = *(const bf16x8*)(kr + c * 8); \
            _Pragma("unroll") for (int e = 0; e < 8; ++e) s += q[c * 8 + e] * bf2f((unsigned short)kv[e]); } \
        if (MODE == 0) s += dk[j]; \
        if (!(valid)) s = -INFINITY; \
        if (s > m) { const float sc = exp2f(m - s); l *= sc; _Pragma("unroll") for (int d = 0; d < 64; ++d) o[d] *= sc; m = s; } \
        const float p = exp2f(s - m); l += p; \
        const bf16_t* vr = Vb + (size_t)(j) * HW; \
        _Pragma("unroll") for (int c = 0; c < 8; ++c) { const bf16x8 vv = *(const bf16x8*)(vr + c * 8); \
            _Pragma("unroll") for (int e = 0; e < 8; ++e) o[c * 8 + e] += p * bf2f((unsigned short)vv[e]); } } while (0)
    if (MODE == 0) {
        for (int j = 0; j <= tmax; ++j) ATT_KEY(j, j <= t);
    } else {
        float g[8]; unsigned sel = 0u;
#pragma unroll
        for (int n = 0; n < 8; ++n) { float s = 0.f; const float* km = KMS + ((size_t)(b * 8 + h) * 8 + n) * 64;
#pragma unroll
            for (int d = 0; d < 64; ++d) s += q[d] * km[d];
            g[n] = (n < qb) ? s : -INFINITY; }
#pragma unroll
        for (int n = 0; n < 8; ++n) { int rank = 0;
#pragma unroll
            for (int k = 0; k < 8; ++k) if (k < qb && (g[k] > g[n] || (g[k] == g[n] && k < n))) ++rank;
            if (n < qb && rank < 3) sel |= 1u << n; }
        for (int j = qb * 256; j <= tmax; ++j) ATT_KEY(j, j <= t);
        for (int n = 0; n < qb; ++n) { const bool mine = (sel >> n) & 1u;
            if (__ballot(mine) == 0ull) continue;
            for (int j = n * 256; j < n * 256 + 256; ++j) ATT_KEY(j, mine); }
    }
#undef ATT_KEY
    const float il = 1.0f / l;
    const bf16_t* gp = H + row * HW + cg; bf16_t* yp = Y + row * DM + (MODE ? 512 : 0) + h * HD;
#pragma unroll
    for (int c = 0; c < 8; ++c) { const bf16x8 gv = *(const bf16x8*)(gp + c * 8); u32x4 w;
#pragma unroll
        for (int e = 0; e < 4; ++e) { const float a = o[c * 8 + 2 * e] * il * silu_f(bf2f((unsigned short)gv[2 * e])), bb = o[c * 8 + 2 * e + 1] * il * silu_f(bf2f((unsigned short)gv[2 * e + 1])); w[e] = f2bf(a) | (f2bf(bb) << 16); }
        *(u32x4*)(yp + c * 8) = w; }
}
__global__ __launch_bounds__(256) void s_ln(const float* __restrict__ xin, const float* __restrict__ F, const float* __restrict__ gam, const float* __restrict__ bet, float* __restrict__ xout, bf16_t* __restrict__ XN) {
    const int lane = threadIdx.x & 63; const size_t m = (size_t)blockIdx.x * 4 + (threadIdx.x >> 6);
    f32x4 z[4]; float s = 0.f;
#pragma unroll
    for (int j = 0; j < 4; ++j) { const f32x4 xv = *(const f32x4*)(xin + m * DM + j * 256 + lane * 4), fv = *(const f32x4*)(F + m * DM + j * 256 + lane * 4); z[j] = xv * ALPHA + fv; s += (z[j][0] + z[j][1]) + (z[j][2] + z[j][3]); }
#pragma unroll
    for (int o = 1; o < 64; o <<= 1) s += __shfl_xor(s, o);
    const float mean = s * (1.f / DM); float q = 0.f;
#pragma unroll
    for (int j = 0; j < 4; ++j) { z[j] = z[j] - mean; q += (z[j][0] * z[j][0] + z[j][1] * z[j][1]) + (z[j][2] * z[j][2] + z[j][3] * z[j][3]); }
#pragma unroll
    for (int o = 1; o < 64; o <<= 1) q += __shfl_xor(q, o);
    const float rstd = 1.0f / sqrtf(q * (1.f / DM) + LN_EPS);
#pragma unroll
    for (int j = 0; j < 4; ++j) { const f32x4 gv = *(const f32x4*)(gam + j * 256 + lane * 4), bv = *(const f32x4*)(bet + j * 256 + lane * 4); const f32x4 y = z[j] * rstd * gv + bv;
        *(f32x4*)(xout + m * DM + j * 256 + lane * 4) = y;
        *(uint2*)(XN + m * DM + j * 256 + lane * 4) = make_uint2(f2bf(y[0]) | (f2bf(y[1]) << 16), f2bf(y[2]) | (f2bf(y[3]) << 16)); }
}
__global__ __launch_bounds__(256) void s_pool(const bf16_t* __restrict__ U, bf16_t* __restrict__ P) {
    const size_t idx = (size_t)blockIdx.x * 256 + threadIdx.x; const int c = (int)(idx % PW); const size_t m = idx / PW; const int t = (int)(m % SEQ);
    const int w = 2 << (c >> 9); const int cnt = (t + 1 < w) ? t + 1 : w; float s = 0.f;
    for (int i = 0; i < cnt; ++i) s += bf2f(U[(m - i) * PW + c]);
    P[idx] = (bf16_t)f2bf(s / (float)cnt - bf2f(U[idx]));
}

static void wt(hipStream_t st, const float* src, int ldsrc, int col0, int K, int ncols, bf16_t* dst) { hipLaunchKernelGGL(s_wt, dim3(ncols / 32, K / 32), dim3(256), 0, st, src, ldsrc, col0, K, ncols, dst); }

extern "C" void kernel_launch(void* const* d_in, const int* in_sizes, int n_in, void* d_out, int out_size, void* d_ws, size_t ws_size, hipStream_t stream) {
    if (ws_size < WS_END) { fprintf(stderr, "kernel_launch: workspace too small: %zu < %zu\n", ws_size, (size_t)WS_END); return; }
    const float* x = (const float*)d_in[0]; const float* attn_w_in = (const float*)d_in[1]; const float* attn_b_f = (const float*)d_in[2]; const float* attn_w_out = (const float*)d_in[3];
    const float* pool_w_in = (const float*)d_in[4]; const float* pool_w_grp = (const float*)d_in[5]; const float* pool_scale = (const float*)d_in[6]; const float* pool_w_out = (const float*)d_in[7];
    const float* ln_g = (const float*)d_in[8]; const float* ln_b = (const float*)d_in[9];
    unsigned char* ws = (unsigned char*)d_ws; float* out = (float*)d_out;
    float* LF = (float*)(ws + WS_LF); float* DK = (float*)(ws + WS_DK); float* KMS = (float*)(ws + WS_KMS);
    bf16_t* XN = (bf16_t*)(ws + WS_XN); bf16_t* R0 = (bf16_t*)(ws + WS_R0); bf16_t* R1 = (bf16_t*)(ws + WS_R1); bf16_t* R2 = (bf16_t*)(ws + WS_R2);
    for (int j = 0; j < 2; ++j) {
        bf16_t* WinA = (bf16_t*)(ws + WS_WINA) + (size_t)j * 4096 * 1024; const float* wi = attn_w_in + (size_t)j * 1024 * 4104;
        wt(stream, wi, 4104, 0, 1024, 2048, WinA); wt(stream, wi, 4104, 2056, 1024, 2048, WinA + (size_t)2048 * 1024);
        bf16_t* Wff = (bf16_t*)(ws + WS_WFFA) + (size_t)j * 16 * 1024;
        hipLaunchKernelGGL(s_zero16, dim3(64), dim3(256), 0, stream, Wff, 16 * 1024);
        hipLaunchKernelGGL(s_wt, dim3(1, 32), dim3(256), 0, stream, wi, 4104, 2048 - 0, 1024, 32, (bf16_t*)(ws + WS_XB));
        hipMemcpyAsync(Wff, ws + WS_XB, 8 * 1024 * 2, hipMemcpyDeviceToDevice, stream);
        wt(stream, attn_w_out + (size_t)j * 1024 * 1024, 1024, 0, 1024, 1024, (bf16_t*)(ws + WS_WOUTA) + (size_t)j * 1024 * 1024);
        wt(stream, pool_w_in + (size_t)j * 1024 * 4096, 4096, 0, 1024, 4096, (bf16_t*)(ws + WS_WINP) + (size_t)j * 4096 * 1024);
        for (int g = 0; g < 4; ++g) wt(stream, pool_w_grp + ((size_t)j * 4 + g) * 512 * 512, 512, 0, 512, 512, (bf16_t*)(ws + WS_WGP) + ((size_t)j * 4 + g) * 512 * 512);
        wt(stream, pool_w_out + (size_t)j * 2048 * 1024, 1024, 0, 2048, 1024, (bf16_t*)(ws + WS_WOUTP) + (size_t)j * 1024 * 2048);
    }
    hipLaunchKernelGGL(s_cvt, dim3((MROWS * DM / 4 + 255) / 256), dim3(256), 0, stream, x, XN, (size_t)MROWS * DM / 4);
    const float* xcur = x;
    for (int layer = 0; layer < 4; ++layer) {
        const int j = layer >> 1; float* F;
        if ((layer & 1) == 0) {
            bf16_t* H = R0; bf16_t* Y = R2; F = (float*)R0;
            const bf16_t* WinA = (const bf16_t*)(ws + WS_WINA) + (size_t)j * 4096 * 1024;
            hipLaunchKernelGGL(s_gemm<EpiInAttn>, dim3(4096 / 128, MROWS / 128, 1), dim3(256), 0, stream, (const bf16_t*)XN, DM, WinA, DM, DM, EpiInAttn{H}, 0, 0, 0);
            hipLaunchKernelGGL(s_ff, dim3(MROWS / 4), dim3(256), 0, stream, (const bf16_t*)XN, (const bf16_t*)(ws + WS_WFFA) + (size_t)j * 16 * 1024, attn_b_f + j * 8, LF);
            hipLaunchKernelGGL(s_cumsum, dim3(BATCH * NH), dim3(256), 0, stream, (const float*)LF, DK);
            hipLaunchKernelGGL(s_kms, dim3(BATCH * NH * 8), dim3(64), 0, stream, (const bf16_t*)H, KMS);
            hipLaunchKernelGGL(s_attn<0>, dim3(BATCH * NH * 8), dim3(256), 0, stream, (const bf16_t*)H, (const float*)DK, (const float*)KMS, Y);
            hipLaunchKernelGGL(s_attn<1>, dim3(BATCH * NH * 8), dim3(256), 0, stream, (const bf16_t*)H, (const float*)DK, (const float*)KMS, Y);
            hipLaunchKernelGGL(s_gemm<EpiF32>, dim3(DM / 128, MROWS / 128, 1), dim3(256), 0, stream, (const bf16_t*)Y, DM, (const bf16_t*)(ws + WS_WOUTA) + (size_t)j * 1024 * 1024, DM, DM, EpiF32{F}, 0, 0, 0);
        } else {
            bf16_t* U = R0; bf16_t* G = R1; bf16_t* P = R2; bf16_t* Y2 = R0; F = (float*)R1;
            hipLaunchKernelGGL(s_gemm<EpiInPool>, dim3(4096 / 128, MROWS / 128, 1), dim3(256), 0, stream, (const bf16_t*)XN, DM, (const bf16_t*)(ws + WS_WINP) + (size_t)j * 4096 * 1024, DM, DM, EpiInPool{U, G}, 0, 0, 0);
            hipLaunchKernelGGL(s_pool, dim3((unsigned)((size_t)MROWS * PW / 256)), dim3(256), 0, stream, (const bf16_t*)U, P);
            hipLaunchKernelGGL(s_gemm<EpiGrp>, dim3(512 / 128, MROWS / 128, 4), dim3(256), 0, stream, (const bf16_t*)P, PW, (const bf16_t*)(ws + WS_WGP) + (size_t)j * 4 * 512 * 512, 512, 512, EpiGrp{G, pool_scale + j * PW, Y2}, 512, 512 * 512, 512);
            hipLaunchKernelGGL(s_gemm<EpiF32>, dim3(DM / 128, MROWS / 128, 1), dim3(256), 0, stream, (const bf16_t*)Y2, PW, (const bf16_t*)(ws + WS_WOUTP) + (size_t)j * 1024 * 2048, PW, PW, EpiF32{F}, 0, 0, 0);
        }
        hipLaunchKernelGGL(s_ln, dim3(MROWS / 4), dim3(256), 0, stream, xcur, (const float*)F, ln_g + layer * DM, ln_b + layer * DM, out, XN);
        xcur = out;
    }
}
```
